# Optimizing an MI355X kernel written in HIP

```python
import jax, jax.numpy as jnp
from jax import lax
import numpy as np

D_MODEL = 1024
BATCH = 1
SEQ = 16384
DEPTH = 4

D_MIX = D_MODEL
A_WIDTH = D_MIX // 2
A_HEADS = 8
A_HEAD_DIM = A_WIDTH // A_HEADS
A_CHUNK = 128
B_WIDTH = D_MIX - A_WIDTH
CONV_WIDTH = 3
PROJ_AB = 2 * A_WIDTH + 3 * B_WIDTH
C_GROUPS = 4
C_WINDOWS = (2, 4, 8, 16)
C_GROUP_DIM = D_MIX // C_GROUPS
N_EXPERTS = 32
TOP_K = 4
D_FF = D_MODEL
SWIGLU_LIMIT = 7.0
SWIGLU_ALPHA = 1.702
MOE_BLOCK = 256
LN_EPS = 1e-5
DEEPNORM_ALPHA = float((2 * DEPTH) ** 0.25)
DEEPNORM_BETA = float((8 * DEPTH) ** -0.25)
N_EVEN = (DEPTH + 1) // 2
N_ODD = DEPTH // 2

kernel_name = "hybrid_gmlp_shortconv_pool_moe_deepnorm"


def layer_norm(x, g, b=None):
    xf = x.astype(jnp.float32)
    mu = jnp.mean(xf, axis=-1, keepdims=True)
    var = jnp.mean(jnp.square(xf - mu), axis=-1, keepdims=True)
    y = (xf - mu) * lax.rsqrt(var + LN_EPS) * g.astype(jnp.float32)
    if b is not None:
        y = y + b.astype(jnp.float32)
    return y.astype(x.dtype)


def spatial_gating(u, v, norm_g, w_s, b_s):
    bsz, s, _ = v.shape
    v = layer_norm(v, norm_g)
    mask = jnp.tril(jnp.ones((A_CHUNK, A_CHUNK), dtype=bool))
    w = jnp.where(mask, w_s, jnp.zeros((), w_s.dtype))
    vc = v.reshape(bsz, s // A_CHUNK, A_CHUNK, A_HEADS, A_HEAD_DIM)
    sv = jnp.einsum('hts,bnshd->bnthd', w, vc) + b_s.T[None, None, :, :, None]
    return u * sv.reshape(bsz, s, A_WIDTH)


def short_gated_conv(g_b, g_c, x_in, conv_w):
    z = g_c * x_in
    s = z.shape[1]
    zp = jnp.pad(z, ((0, 0), (CONV_WIDTH - 1, 0), (0, 0)))
    conv = conv_w[0] * zp[:, 0:s]
    for k in range(1, CONV_WIDTH):
        conv = conv + conv_w[k] * zp[:, k:k + s]
    return g_b * conv


def multiscale_pool(z, w_grp, scale):
    bsz, s, _ = z.shape
    zf = z.astype(jnp.float32).reshape(bsz, s, C_GROUPS, C_GROUP_DIM)
    cs = jnp.cumsum(zf, axis=1)
    pos = jnp.arange(s)
    outs = []
    for g, win in enumerate(C_WINDOWS):
        csg = cs[:, :, g]
        lag = jnp.pad(csg, ((0, 0), (win, 0), (0, 0)))[:, :s]
        cnt = jnp.minimum(pos + 1, win).astype(jnp.float32)[None, :, None]
        outs.append((csg - lag) / cnt - zf[:, :, g])
    pooled = jnp.stack(outs, axis=2).astype(z.dtype)
    mixed = jnp.einsum('bsgc,gcd->bsgd', pooled, w_grp)
    return mixed.reshape(bsz, s, D_MIX) * scale


def clamped_swiglu(h):
    gate, lin = h[..., :D_FF], h[..., D_FF:]
    gate = jnp.minimum(gate, SWIGLU_LIMIT)
    lin = jnp.clip(lin, -SWIGLU_LIMIT, SWIGLU_LIMIT)
    return (lin + 1.0) * gate * jax.nn.sigmoid(SWIGLU_ALPHA * gate)


def moe_ffn(x, router_w, router_b, w_up, b_up, w_down, b_down):
    bsz, s, d = x.shape
    xt = x.reshape(-1, d)
    n_tok = xt.shape[0]
    logits = (xt @ router_w + router_b).astype(jnp.float32)
    top_val, top_idx = lax.top_k(logits, TOP_K)
    gates = jax.nn.softmax(top_val, axis=-1).astype(x.dtype)

    n_pair = n_tok * TOP_K
    flat_e = top_idx.reshape(-1)
    order = jnp.argsort(flat_e)
    e_sorted = flat_e[order]
    tok_sorted = order // TOP_K
    counts = jnp.bincount(flat_e, length=N_EXPERTS)
    starts = jnp.cumsum(counts) - counts
    padded_counts = (counts + MOE_BLOCK - 1) // MOE_BLOCK * MOE_BLOCK
    padded_ends = jnp.cumsum(padded_counts)
    padded_starts = padded_ends - padded_counts
    dest = padded_starts[e_sorted] + (jnp.arange(n_pair) - starts[e_sorted])
    n_blocks = -(-n_pair // MOE_BLOCK) + N_EXPERTS
    x_pad = jnp.zeros((n_blocks * MOE_BLOCK, d), x.dtype).at[dest].set(xt[tok_sorted])
    block_start = jnp.arange(n_blocks) * MOE_BLOCK
    block_expert = jnp.minimum(
        jnp.searchsorted(padded_ends, block_start, side='right'), N_EXPERTS - 1)

    def expert_block(args):
        xb, e = args
        h = xb @ w_up[e] + b_up[e]
        return clamped_swiglu(h) @ w_down[e] + b_down[e]

    y_pad = lax.map(expert_block, (x_pad.reshape(n_blocks, MOE_BLOCK, d), block_expert))
    y_sorted = y_pad.reshape(-1, d)[dest]
    y_pairs = jnp.zeros_like(y_sorted).at[order].set(y_sorted).reshape(n_tok, TOP_K, d)
    return jnp.einsum('tkd,tk->td', y_pairs, gates).reshape(bsz, s, d)


def setup_inputs(seed: int = 0) -> dict:
    key = jax.random.key(seed)
    ks = jax.random.split(key, 24)
    f32 = jnp.float32
    nrm = lambda k, shape, scale: jax.random.normal(k, shape, f32) * scale
    d_in = D_MODEL ** -0.5
    return {
        "x": nrm(ks[0], (BATCH, SEQ, D_MODEL), 1.0),
        "ab_w_in": nrm(ks[1], (N_EVEN, D_MODEL, PROJ_AB), d_in),
        "a_norm_g": 1.0 + nrm(ks[2], (N_EVEN, A_WIDTH), 0.05),
        "a_w_s": nrm(ks[3], (N_EVEN, A_HEADS, A_CHUNK, A_CHUNK), A_CHUNK ** -0.5),
        "a_b_s": 1.0 + nrm(ks[4], (N_EVEN, A_HEADS, A_CHUNK), 0.05),
        "b_conv_w": nrm(ks[5], (N_EVEN, CONV_WIDTH, B_WIDTH), CONV_WIDTH ** -0.5),
        "ab_w_out": nrm(ks[6], (N_EVEN, D_MIX, D_MODEL), D_MIX ** -0.5 * DEEPNORM_BETA),
        "c_w_in": nrm(ks[7], (N_ODD, D_MODEL, D_MIX), d_in),
        "c_w_grp": nrm(ks[8], (N_ODD, C_GROUPS, C_GROUP_DIM, C_GROUP_DIM), C_GROUP_DIM ** -0.5),
        "c_scale": 1.0 + nrm(ks[9], (N_ODD, D_MIX), 0.05),
        "c_w_out": nrm(ks[10], (N_ODD, D_MIX, D_MODEL), D_MIX ** -0.5 * DEEPNORM_BETA),
        "ln_mix_g": 1.0 + nrm(ks[11], (DEPTH, D_MODEL), 0.05),
        "ln_mix_b": nrm(ks[12], (DEPTH, D_MODEL), 0.02),
        "router_w": nrm(ks[13], (DEPTH, D_MODEL, N_EXPERTS), d_in),
        "router_b": nrm(ks[14], (DEPTH, N_EXPERTS), 0.01),
        "moe_w_up": nrm(ks[15], (DEPTH, N_EXPERTS, D_MODEL, 2 * D_FF), d_in),
        "moe_b_up": nrm(ks[16], (DEPTH, N_EXPERTS, 2 * D_FF), 0.02),
        "moe_w_down": nrm(ks[17], (DEPTH, N_EXPERTS, D_FF, D_MODEL), D_FF ** -0.5 * DEEPNORM_BETA),
        "moe_b_down": nrm(ks[18], (DEPTH, N_EXPERTS, D_MODEL), 0.02),
        "ln_ffn_g": 1.0 + nrm(ks[19], (DEPTH, D_MODEL), 0.05),
        "ln_ffn_b": nrm(ks[20], (DEPTH, D_MODEL), 0.02),
    }


def reference(x, ab_w_in, a_norm_g, a_w_s, a_b_s, b_conv_w, ab_w_out,
              c_w_in, c_w_grp, c_scale, c_w_out, ln_mix_g, ln_mix_b,
              router_w, router_b, moe_w_up, moe_b_up, moe_w_down, moe_b_down,
              ln_ffn_g, ln_ffn_b):
    splits = [A_WIDTH, 2 * A_WIDTH, 2 * A_WIDTH + B_WIDTH, 2 * A_WIDTH + 2 * B_WIDTH]
    for layer in range(DEPTH):
        i = layer // 2
        if layer % 2 == 0:
            z = x @ ab_w_in[i]
            u, v, g_b, g_c, x_in = jnp.split(z, splits, axis=-1)
            y_a = spatial_gating(jax.nn.gelu(u, approximate=False),
                                 jax.nn.gelu(v, approximate=False),
                                 a_norm_g[i], a_w_s[i], a_b_s[i])
            y_b = short_gated_conv(g_b, g_c, x_in, b_conv_w[i])
            mix = jnp.concatenate([y_a, y_b], axis=-1) @ ab_w_out[i]
        else:
            mix = multiscale_pool(x @ c_w_in[i], c_w_grp[i], c_scale[i]) @ c_w_out[i]
        x = layer_norm(DEEPNORM_ALPHA * x + mix, ln_mix_g[layer], ln_mix_b[layer])
        ffn = moe_ffn(x, router_w[layer], router_b[layer], moe_w_up[layer],
                      moe_b_up[layer], moe_w_down[layer], moe_b_down[layer])
        x = layer_norm(DEEPNORM_ALPHA * x + ffn, ln_ffn_g[layer], ln_ffn_b[layer])
    return x
```

```cpp
#include <hip/hip_runtime.h>
#include <cstdio>
#include <cstdint>

#ifndef MK_PER_PHASE
#define MK_PER_PHASE 1
#endif

namespace pg8 {
#define PG8_LAS __attribute__((address_space(3)))
typedef unsigned short bf16_t;
typedef short bf16x8 __attribute__((ext_vector_type(8)));
typedef float f32x4 __attribute__((ext_vector_type(4)));
typedef float f32x2 __attribute__((ext_vector_type(2)));
typedef unsigned u32x4 __attribute__((ext_vector_type(4)));
typedef unsigned u32x2 __attribute__((ext_vector_type(2)));
constexpr int BM = 256, BK = 64, HALF = 128, HTB = HALF * BK * 2  , STAGE_BYTES = 8 * HTB, NXCD = 8, WGM = 8;

__host__ __device__ __forceinline__ int lds_byte(int r, int c) { const int st = (r >> 4) * 2 + (c >> 5), rr = r & 15, cc = c & 31, ob = rr * 64 + cc * 2; return st * 1024 + (ob ^ (((ob >> 9) & 1) << 5)); }
__host__ __device__ __forceinline__ void stage_rc(int b, int& R, int& C) { const int st = b / 1024, sb = b % 1024, swz = sb ^ (((sb >> 9) & 1) << 5); R = (st >> 1) * 16 + swz / 64; C = (st & 1) * 32 + (swz % 64) / 2; }
__host__ __device__ __forceinline__ int perm32(int rho) { const int n = rho >> 4, i = rho & 15; return 8 * (i >> 2) + 4 * n + (i & 3); }

struct Unit { const char* A; const char* B; int orow, ocol, voff, flag; };

struct DenseOrder {
    const char* A; const char* B; int lda, ldb, acolstep; int nM, nN, nwg, G, c;
    __device__ void init(const void* A_, const void* B_, int lda_, int ldb_, int acolstep_, int M, int N, int G_, int c_) { A = (const char*)A_; B = (const char*)B_; lda = lda_; ldb = ldb_; acolstep = acolstep_; nM = M / BM; nN = N / BM; nwg = nM * nN; G = G_; c = c_; }
    __device__ __forceinline__ bool next(int i, Unit& u) const {
        const long L = (long)i * G + c; if (L >= nwg) return false;
        int wgid = (int)L; { const int q = nwg / NXCD, r = nwg % NXCD, xcd = wgid % NXCD, off = wgid / NXCD; wgid = (xcd < r ? xcd * (q + 1) : r * (q + 1) + (xcd - r) * q) + off; }
        const int nig = WGM * nN, gid = wgid / nig, fm = gid * WGM, gsz = (nM - fm) < WGM ? (nM - fm) : WGM;
        const int pm = fm + ((wgid % nig) % gsz), pn = (wgid % nig) / gsz;
        u.A = A + (size_t)pm * BM * lda * 2 + (size_t)pn * acolstep; u.B = B + (size_t)pn * BM * ldb * 2; u.orow = pm * BM; u.ocol = pn * BM; u.voff = pn * BM; u.flag = pn; return true;
    }
};
struct ListOrder {
    const PG8_LAS int* list; const char* A; const char* B; size_t a_estride, b_estride; int lda, ldb, cap, ocolstep, voff_e, voff_j;
    __device__ __forceinline__ bool next(int i, Unit& u) const {
        const int p = __builtin_amdgcn_readfirstlane(list[i]); if (p < 0) return false;
        const int e = p & 255, mi = (p >> 8) & 4095, j = p >> 20;
        u.A = A + (size_t)e * a_estride + (size_t)mi * BM * lda * 2; u.B = B + (size_t)e * b_estride + (size_t)j * BM * ldb * 2;
        u.orow = e * cap + mi * BM; u.ocol = j * ocolstep; u.voff = e * voff_e + j * voff_j; u.flag = e; return true;
    }
};

__device__ __forceinline__ unsigned cvt_pk_bf16(float lo, float hi) { unsigned r; asm volatile("v_cvt_pk_bf16_f32 %0, %1, %2" : "=v"(r) : "v"(lo), "v"(hi)); return r; }
__device__ __forceinline__ f32x2 gelu_pk(f32x2 v) {
    const f32x2 av = __builtin_elementwise_abs(v), d = av * 0.2316418882f + 1.0f;
    f32x2 t; t.x = __builtin_amdgcn_rcpf(d.x); t.y = __builtin_amdgcn_rcpf(d.y);
    f32x2 q = t * 0.5307027145f + (-0.7265760135f); q = q * t + 0.7107068705f; q = q * t + (-0.142248368f); q = q * t + 0.127414796f; q = q * t;
    const f32x2 s = (v * v) * (-0.72134752044f);
    f32x2 e; e.x = __builtin_amdgcn_exp2f(s.x); e.y = __builtin_amdgcn_exp2f(s.y);
    const f32x2 m = v * (q * e), r = v - m;
    f32x2 o; o.x = v.x < 0.f ? m.x : r.x; o.y = v.y < 0.f ? m.y : r.y; return o;
}

struct EpiB16 {
    static constexpr bool PERM = true;
    bf16_t* O; int ldc; const float* bias; const float* scale; int ngelu;
    __device__ __forceinline__ void operator()(const f32x4 (&acc)[2][2][4][2], const Unit& u, int wr, int wc, int fr, int fq) const {
        const int row0 = u.orow + wr * 64 + fr, col0 = u.ocol + wc * 32 + 8 * fq, vcol0 = u.voff + wc * 32 + 8 * fq;
        const bool act = u.flag < ngelu;
#pragma unroll
        for (int bj = 0; bj < 2; ++bj) {
            f32x4 bv[2], sv[2];
#pragma unroll
            for (int n = 0; n < 2; ++n) { bv[n] = bias ? *(const f32x4*)(bias + vcol0 + bj * HALF + 4 * n) : (f32x4){0.f, 0.f, 0.f, 0.f};
                                          sv[n] = scale ? *(const f32x4*)(scale + vcol0 + bj * HALF + 4 * n) : (f32x4){1.f, 1.f, 1.f, 1.f}; }
#pragma unroll
            for (int ai = 0; ai < 2; ++ai)
#pragma unroll
                for (int m = 0; m < 4; ++m) { bf16_t* rowp = O + (size_t)(row0 + ai * HALF + m * 16) * ldc + col0;
                    f32x4 v0 = (acc[ai][bj][m][0] + bv[0]) * sv[0], v1 = (acc[ai][bj][m][1] + bv[1]) * sv[1];
                    if (act) { f32x2 a = gelu_pk((f32x2){v0[0], v0[1]}), b = gelu_pk((f32x2){v0[2], v0[3]}), c = gelu_pk((f32x2){v1[0], v1[1]}), d = gelu_pk((f32x2){v1[2], v1[3]});
                        v0 = (f32x4){a.x, a.y, b.x, b.y}; v1 = (f32x4){c.x, c.y, d.x, d.y}; }
                    u32x4 w; w.x = cvt_pk_bf16(v0[0], v0[1]); w.y = cvt_pk_bf16(v0[2], v0[3]); w.z = cvt_pk_bf16(v1[0], v1[1]); w.w = cvt_pk_bf16(v1[2], v1[3]);
                    *(u32x4*)(rowp + bj * HALF) = w; }
        }
    }
};
struct EpiRes {
    static constexpr bool PERM = false;
    float* X; int ldc; float alpha;
    __device__ __forceinline__ void operator()(const f32x4 (&acc)[2][2][4][2], const Unit& u, int wr, int wc, int fr, int fq) const {
        const int row0 = u.orow + wr * 64 + fr, col0 = u.ocol + wc * 32 + 4 * fq;
#pragma unroll
        for (int ai = 0; ai < 2; ++ai)
#pragma unroll
            for (int m = 0; m < 4; ++m) { float* rowp = X + (size_t)(row0 + ai * HALF + m * 16) * ldc + col0;
                f32x4 o[2][2];
#pragma unroll
                for (int bj = 0; bj < 2; ++bj)
#pragma unroll
                    for (int n = 0; n < 2; ++n) o[bj][n] = *(const f32x4*)(rowp + bj * HALF + n * 16);
#pragma unroll
                for (int bj = 0; bj < 2; ++bj)
#pragma unroll
                    for (int n = 0; n < 2; ++n) *(f32x4*)(rowp + bj * HALF + n * 16) = o[bj][n] * alpha + acc[ai][bj][m][n];
                asm volatile("" ::: "memory"); }
    }
};
struct EpiSwiglu {
    static constexpr bool PERM = false;
    bf16_t* H; const float* bup;
    __device__ __forceinline__ void operator()(const f32x4 (&acc)[2][2][4][2], const Unit& u, int wr, int wc, int fr, int fq) const {
        const int row0 = u.orow + wr * 64 + fr, a0 = wc * 16 + 4 * fq;
        f32x4 bg[2], bl[2];
#pragma unroll
        for (int bj = 0; bj < 2; ++bj) { bg[bj] = *(const f32x4*)(bup + u.voff + bj * 64 + a0); bl[bj] = *(const f32x4*)(bup + u.voff + 1024 + bj * 64 + a0); }
#pragma unroll
        for (int ai = 0; ai < 2; ++ai)
#pragma unroll
            for (int m = 0; m < 4; ++m) { bf16_t* rowp = H + (size_t)(row0 + ai * HALF + m * 16) * 1024 + u.ocol + a0;
#pragma unroll
                for (int bj = 0; bj < 2; ++bj) { const f32x4 g4 = acc[ai][bj][m][0] + bg[bj], l4 = acc[ai][bj][m][1] + bl[bj]; float r[4];
#pragma unroll
                    for (int i = 0; i < 4; ++i) { const float g = fminf(g4[i], 7.0f), l = fminf(fmaxf(l4[i], -7.0f), 7.0f);
                        const float sg = __builtin_amdgcn_rcpf(1.0f + __builtin_amdgcn_exp2f(g * (-1.702f * 1.4426950408889634f)));
                        r[i] = (l + 1.0f) * g * sg; }
                    u32x2 w; w.x = cvt_pk_bf16(r[0], r[1]); w.y = cvt_pk_bf16(r[2], r[3]);
                    *(u32x2*)(rowp + bj * 64) = w; } }
    }
};

template <class Epi, class Sched, bool ALIGN_EPI = true, bool SP2 = true>
__device__ __forceinline__ void gemm_phase(PG8_LAS unsigned char* lds, const int K, const int lda, const int ldb, const Sched& S, const Epi& E) {
    int tid_ = threadIdx.x; asm volatile("" : "+v"(tid_));
    const int tid = tid_, wid = __builtin_amdgcn_readfirstlane(tid >> 6), lane = tid & 63, wr = wid >> 2, wc = wid & 3, fr = lane & 15, fq = lane >> 4;
    const int nt = K / BK;
    unsigned voffA[2], voffB[2];
#pragma unroll
    for (int i = 0; i < 2; ++i) { int R, C; stage_rc(tid * 16 + i * 8192, R, C); const int Rb = Epi::PERM ? ((R & ~31) + perm32(R & 31)) : R;
        voffA[i] = (unsigned)(R * lda + C) * 2u; voffB[i] = (unsigned)(Rb * ldb + C) * 2u; }
    const size_t kstep = (size_t)(BK * 2);
    const size_t hstepA = (size_t)HALF * lda * 2, hstepB = (size_t)HALF * ldb * 2;
    const unsigned ldsw = (unsigned)wid * 1024u;
    const int aoff = lds_byte(wr * 64 + fr, fq * 8), boff = lds_byte(wc * 32 + fr, fq * 8);
#define PG8_SA(b, h) (((b) * 2 + (h)) * HTB)
#define PG8_SB(b, h) ((4 + (b) * 2 + (h)) * HTB)
#define PG8_STAGE(bufoff, gbase, voff) do { _Pragma("unroll") for (int _i = 0; _i < 2; ++_i) \
        __builtin_amdgcn_global_load_lds((const unsigned*)((const char*)(gbase) + (voff)[_i]), (PG8_LAS unsigned*)(lds + (bufoff) + ldsw + _i * 8192), 16, 0, 0); } while (0)
#define PG8_LDA(dst, b, h) do { _Pragma("unroll") for (int m = 0; m < 4; ++m) _Pragma("unroll") for (int k = 0; k < 2; ++k) dst[m][k] = *(const PG8_LAS bf16x8*)(lds + PG8_SA(b, h) + aoff + m * 2048 + k * 1024); } while (0)
#define PG8_LDB(dst, b, h) do { _Pragma("unroll") for (int n = 0; n < 2; ++n) _Pragma("unroll") for (int k = 0; k < 2; ++k) dst[n][k] = *(const PG8_LAS bf16x8*)(lds + PG8_SB(b, h) + boff + n * 2048 + k * 1024); } while (0)
#define PG8_MMA(ai, bj, At, Bt) do { __builtin_amdgcn_s_setprio(1); _Pragma("unroll") for (int m = 0; m < 4; ++m) _Pragma("unroll") for (int n = 0; n < 2; ++n) _Pragma("unroll") for (int k = 0; k < 2; ++k) \
        acc[ai][bj][m][n] = __builtin_amdgcn_mfma_f32_16x16x32_bf16(Bt[n][k], At[m][k], acc[ai][bj][m][n], 0, 0, 0); __builtin_amdgcn_s_setprio(0); } while (0)
#define PG8_WAIT_V(n) asm volatile("s_waitcnt vmcnt(" #n ")" ::: "memory")
#define PG8_WAIT_L(n) asm volatile("s_waitcnt lgkmcnt(" #n ")" ::: "memory")
#define PG8_BAR __builtin_amdgcn_s_barrier()
#define PG8_SCHED __builtin_amdgcn_sched_barrier(0)
    Unit cur, nxt; int ui = 0;
    if (!S.next(0, cur)) return;
    f32x4 acc[2][2][4][2];
#pragma unroll
    for (int a = 0; a < 2; ++a)
#pragma unroll
        for (int b = 0; b < 2; ++b)
#pragma unroll
            for (int m = 0; m < 4; ++m)
#pragma unroll
                for (int n = 0; n < 2; ++n) acc[a][b][m][n] = (f32x4){0.f, 0.f, 0.f, 0.f};
    bf16x8 At[4][2], B0[2][2], B1[2][2];
    const char* cA = cur.A; const char* cB = cur.B;
    if constexpr (SP2) {
        PG8_STAGE(PG8_SB(0, 0), cB, voffB); PG8_STAGE(PG8_SB(0, 1), cB + hstepB, voffB); PG8_STAGE(PG8_SA(0, 0), cA, voffA); PG8_STAGE(PG8_SA(0, 1), cA + hstepA, voffA);
        if (wr == 1) PG8_BAR;
        PG8_WAIT_V(2); PG8_BAR;
        PG8_STAGE(PG8_SB(1, 0), cB + kstep, voffB); PG8_STAGE(PG8_SA(1, 0), cA + kstep, voffA); PG8_STAGE(PG8_SB(1, 1), cB + hstepB + kstep, voffB);
        PG8_WAIT_V(6); PG8_BAR;
    } else {
        PG8_STAGE(PG8_SB(0, 0), cB, voffB); PG8_STAGE(PG8_SA(0, 0), cA, voffA); PG8_STAGE(PG8_SB(0, 1), cB + hstepB, voffB); PG8_STAGE(PG8_SA(0, 1), cA + hstepA, voffA);
        if (wr == 1) PG8_BAR;
        PG8_WAIT_V(4); PG8_BAR;
        PG8_STAGE(PG8_SB(1, 0), cB + kstep, voffB); PG8_STAGE(PG8_SA(1, 0), cA + kstep, voffA); PG8_STAGE(PG8_SB(1, 1), cB + hstepB + kstep, voffB);
        PG8_WAIT_V(6); PG8_BAR;
    }
#pragma unroll 1
    for (;;) {
        const bool has_next = S.next(ui + 1, nxt);
        const char* nA = has_next ? nxt.A : cA; const char* nB = has_next ? nxt.B : cB;
#pragma unroll 1
        for (int t = 0; t < nt; t += 2) {
            const bool last = (t == nt - 2);
            const char* a1 = cA + (size_t)(t + 1) * kstep;
            const char* a2 = last ? nA : cA + (size_t)(t + 2) * kstep; const char* b2 = last ? nB : cB + (size_t)(t + 2) * kstep;
            const char* a3 = a2 + kstep; const char* b3 = b2 + kstep;
            if constexpr (SP2) {
            PG8_LDB(B0, 0, 0); PG8_LDB(B1, 0, 1); PG8_SCHED; PG8_LDA(At, 0, 0); PG8_STAGE(PG8_SA(1, 1), a1 + hstepA, voffA);
            PG8_WAIT_V(8); PG8_WAIT_L(0); PG8_BAR; PG8_MMA(0, 0, At, B0); PG8_MMA(0, 1, At, B1); PG8_BAR; PG8_SCHED;
            PG8_LDA(At, 0, 1); PG8_STAGE(PG8_SB(0, 0), b2, voffB); PG8_STAGE(PG8_SB(0, 1), b2 + hstepB, voffB); PG8_STAGE(PG8_SA(0, 0), a2, voffA);
            PG8_WAIT_V(8); PG8_WAIT_L(0); PG8_BAR; PG8_MMA(1, 0, At, B0); PG8_MMA(1, 1, At, B1); PG8_BAR; PG8_SCHED;
            PG8_LDB(B0, 1, 0); PG8_LDB(B1, 1, 1); PG8_SCHED; PG8_LDA(At, 1, 0); PG8_STAGE(PG8_SA(0, 1), a2 + hstepA, voffA);
            PG8_WAIT_V(8); PG8_WAIT_L(0); PG8_BAR; PG8_MMA(0, 0, At, B0); PG8_MMA(0, 1, At, B1); PG8_BAR; PG8_SCHED;
            PG8_LDA(At, 1, 1); PG8_STAGE(PG8_SB(1, 0), b3, voffB); PG8_STAGE(PG8_SB(1, 1), b3 + hstepB, voffB); PG8_STAGE(PG8_SA(1, 0), a3, voffA);
            PG8_WAIT_V(8); PG8_WAIT_L(0); PG8_BAR; PG8_MMA(1, 0, At, B0); PG8_MMA(1, 1, At, B1); PG8_BAR; PG8_SCHED;
            } else {
            PG8_LDB(B0, 0, 0); PG8_SCHED; PG8_LDA(At, 0, 0); PG8_STAGE(PG8_SA(1, 1), a1 + hstepA, voffA);
            PG8_WAIT_L(8); PG8_BAR; PG8_WAIT_L(0); PG8_MMA(0, 0, At, B0); PG8_BAR; PG8_SCHED;
            PG8_LDB(B1, 0, 1); PG8_STAGE(PG8_SB(0, 0), b2, voffB);
            PG8_BAR; PG8_WAIT_L(0); PG8_MMA(0, 1, At, B1); PG8_BAR;
            PG8_LDA(At, 0, 1); PG8_STAGE(PG8_SA(0, 0), a2, voffA);
            PG8_BAR; PG8_WAIT_L(0); PG8_MMA(1, 0, At, B0); PG8_BAR; PG8_SCHED;
            PG8_STAGE(PG8_SB(0, 1), b2 + hstepB, voffB);
            PG8_WAIT_V(6); PG8_BAR; PG8_MMA(1, 1, At, B1); PG8_BAR;
            PG8_LDB(B0, 1, 0); PG8_SCHED; PG8_LDA(At, 1, 0); PG8_STAGE(PG8_SA(0, 1), a2 + hstepA, voffA);
            PG8_WAIT_L(8); PG8_BAR; PG8_WAIT_L(0); PG8_MMA(0, 0, At, B0); PG8_BAR; PG8_SCHED;
            PG8_LDB(B1, 1, 1); PG8_STAGE(PG8_SB(1, 0), b3, voffB);
            PG8_BAR; PG8_WAIT_L(0); PG8_MMA(0, 1, At, B1); PG8_BAR;
            PG8_LDA(At, 1, 1); PG8_STAGE(PG8_SA(1, 0), a3, voffA);
            PG8_BAR; PG8_WAIT_L(0); PG8_MMA(1, 0, At, B0); PG8_BAR; PG8_SCHED;
            PG8_STAGE(PG8_SB(1, 1), b3 + hstepB, voffB);
            PG8_WAIT_V(6); PG8_BAR; PG8_MMA(1, 1, At, B1); PG8_BAR;
            }
        }
        if constexpr (ALIGN_EPI) { if (wr == 0) PG8_BAR; }
        E(acc, cur, wr, wc, fr, fq);
        if (!has_next) break;
#pragma unroll
        for (int a = 0; a < 2; ++a)
#pragma unroll
            for (int b = 0; b < 2; ++b)
#pragma unroll
                for (int m = 0; m < 4; ++m)
#pragma unroll
                    for (int n = 0; n < 2; ++n) acc[a][b][m][n] = (f32x4){0.f, 0.f, 0.f, 0.f};
        cur = nxt; cA = nA; cB = nB; ++ui;
        if constexpr (ALIGN_EPI) { if (wr == 1) PG8_BAR; }
    }
    PG8_WAIT_V(0);
    if constexpr (!ALIGN_EPI) { if (wr == 0) PG8_BAR; }
    PG8_BAR;
#undef PG8_SA
#undef PG8_SB
#undef PG8_STAGE
#undef PG8_LDA
#undef PG8_LDB
#undef PG8_MMA
#undef PG8_WAIT_V
#undef PG8_WAIT_L
#undef PG8_BAR
#undef PG8_SCHED
}
}

constexpr int NWAVES = 8;
constexpr int M = 16384, D = 1024, DEPTH = 4, NE = 32, PROJ = 2560, CAP = 16384;
constexpr float LN_EPS = 1e-5f;
constexpr float ALPHA = 1.6817928305074290861f;

constexpr size_t MiB = 1ull << 20;
constexpr size_t WS_CTL = 0, CTL_ZERO_BYTES = 1 * MiB;
constexpr size_t WS_WIN = 2 * MiB;
constexpr size_t WS_WOUT = 12 * MiB;
constexpr size_t WS_CIN = 16 * MiB;
constexpr size_t WS_COUT = 20 * MiB;
constexpr size_t WS_CGRP = 24 * MiB;
constexpr size_t WS_WSB = 25 * MiB;
constexpr size_t WS_WUP = 32 * MiB;
constexpr size_t WS_WDN = 544 * MiB;
constexpr size_t WS_X = 800 * MiB;
constexpr size_t WS_XB = 864 * MiB;
constexpr size_t WS_Z = 896 * MiB;
constexpr size_t WS_Y = 976 * MiB;
constexpr size_t WS_ROWMAP = 1008 * MiB;
constexpr size_t WS_GATES = 1008 * MiB + 512 * 1024;
constexpr size_t WS_XPAD = 1024 * MiB;
constexpr size_t WS_HACT = 2048 * MiB;
constexpr size_t WS_END = 3072 * MiB;
constexpr int CW_TMO = 0, CW_CODE = 1, CW_BAR = 4096, CW_CNT = 16384;

constexpr int SCR_BYTES = 143360;
constexpr int LDSCTL_OFF = SCR_BYTES, LIST_OFF = LDSCTL_OFF, MISC_OFF = LDSCTL_OFF + 320;
constexpr int LDS_BYTES = 147456;
static_assert(MISC_OFF + 128 <= LDS_BYTES, "LDS map");

#define GAS __attribute__((address_space(1)))
#define LAS __attribute__((address_space(3)))
typedef unsigned short bf16;
typedef unsigned v4u __attribute__((ext_vector_type(4)));
typedef unsigned v2u __attribute__((ext_vector_type(2)));
typedef float f32x4 __attribute__((ext_vector_type(4)));
typedef short bf16x8 __attribute__((ext_vector_type(8)));
typedef GAS unsigned gu32;
#define RLX_AGENT __ATOMIC_RELAXED, __HIP_MEMORY_SCOPE_AGENT
#define LDS_WAIT() asm volatile("s_waitcnt lgkmcnt(0)" ::: "memory")
#define VM_WAIT() asm volatile("s_waitcnt vmcnt(0)" ::: "memory")
__device__ __forceinline__ unsigned pk2(float lo, float hi) { return pg8::cvt_pk_bf16(lo, hi); }
__device__ __forceinline__ float bflo(unsigned w) { return __uint_as_float(w << 16); }
__device__ __forceinline__ float bfhi(unsigned w) { return __uint_as_float(w & 0xffff0000u); }

#define XB_TMO      128
#define XB_XCNT(j)  (256  + 64 * (j))
#define XB_XSUB(j)  (1280 + 64 * (j))
#define XB_XGEN(j)  (2304 + 64 * (j))
#define XB_TOP      3328
#define XB_TOPGEN   3392
#define XCD_BAR_WORDS 3456
#define XB_SPIN_CAP (1u << 18)
__device__ __forceinline__ unsigned xb_ld(unsigned* p)              { return __hip_atomic_load(p, __ATOMIC_RELAXED, __HIP_MEMORY_SCOPE_AGENT); }
__device__ __forceinline__ unsigned xb_add(unsigned* p, unsigned v) { return __hip_atomic_fetch_add(p, v, __ATOMIC_RELAXED, __HIP_MEMORY_SCOPE_AGENT); }
__device__ __forceinline__ unsigned xb_xcc_id() { return (unsigned)__builtin_amdgcn_s_getreg((3 << 11) | 20) & 0xFu; }
#define XB_SPIN(cond, bar) do { unsigned _sp = 0; while (cond) { __builtin_amdgcn_s_sleep(1); \
    if ((++_sp & 255u) == 0u) { if (xb_ld(&(bar)[XB_TMO])) break; if (_sp > XB_SPIN_CAP) { atomicAdd(&(bar)[XB_TMO], 1u); break; } } } } while (0)
struct XcdBarrier { unsigned* bar; unsigned x; volatile LAS unsigned* st; };
__device__ __forceinline__ XcdBarrier xcd_barrier_post(unsigned* bar, volatile LAS unsigned* st) {
    XcdBarrier b; b.bar = bar; b.x = xb_xcc_id(); b.st = st;
    if (threadIdx.x == 0) (void)xb_add(&bar[XB_XCNT(b.x)], 1u);
    return b;
}
__device__ __forceinline__ void xcd_barrier_complete(unsigned* bar, unsigned x, unsigned& nloc, unsigned& nx) {
    const unsigned G = gridDim.x * gridDim.y * gridDim.z;
    unsigned sum, cnt, mine, sp = 0u;
    for (;;) {
        sum = 0u; cnt = 0u; mine = 0u;
#pragma unroll
        for (unsigned j = 0; j < 16; ++j) { const unsigned c = xb_ld(&bar[XB_XCNT(j)]); sum += c; cnt += (c > 0u) ? 1u : 0u; mine = (j == x) ? c : mine; }
        if (sum == G) break;
        __builtin_amdgcn_s_sleep(1);
        if ((++sp & 255u) == 0u) { if (xb_ld(&bar[XB_TMO])) break; if (sp > XB_SPIN_CAP) { atomicAdd(&bar[XB_TMO], 1u); break; } }
    }
    nloc = mine > 0u ? mine : 1u; nx = cnt > 0u ? cnt : 1u;
}
__device__ __forceinline__ void xcd_barrier(const XcdBarrier& b) {
    asm volatile("s_waitcnt vmcnt(0)" ::: "memory");
    __syncthreads();
    if (threadIdx.x == 0) {
        unsigned* bar = b.bar;
        __builtin_amdgcn_s_waitcnt(0);
        unsigned nloc = b.st[0], nx = b.st[1];
        if (nloc == 0u) { xcd_barrier_complete(bar, b.x, nloc, nx); b.st[0] = nloc; b.st[1] = nx; }
        const unsigned old = xb_add(&bar[XB_XSUB(b.x)], 1u);
        const unsigned gen = old / nloc;
        if (old + 1u == (gen + 1u) * nloc) {
            __builtin_amdgcn_fence(__ATOMIC_RELEASE, "agent");
            asm volatile("s_waitcnt vmcnt(0)" ::: "memory");
            const unsigned og = xb_add(&bar[XB_TOP], 1u);
            const unsigned tg = og / nx;
            if (og + 1u == (tg + 1u) * nx) xb_add(&bar[XB_TOPGEN], 1u);
            else XB_SPIN(xb_ld(&bar[XB_TOPGEN]) == tg, bar);
            __builtin_amdgcn_fence(__ATOMIC_ACQUIRE, "agent");
            xb_add(&bar[XB_XGEN(b.x)], 1u);
            asm volatile("s_waitcnt vmcnt(0)" ::: "memory");
        } else {
            XB_SPIN(xb_ld(&bar[XB_XGEN(b.x)]) == gen, bar);
            __builtin_amdgcn_fence(__ATOMIC_ACQUIRE, "agent");
            asm volatile("s_waitcnt vmcnt(0)" ::: "memory");
        }
    }
    __syncthreads();
}

struct Frame {
    LAS unsigned char* lds;
    volatile LAS unsigned* MISC;
    unsigned* ctl;
    unsigned char* ws;
    int tid, lane, wave, vcu, G;
    const __attribute__((address_space(4))) char* kargs;
};
__device__ __forceinline__ const float* inp(const Frame& F, int i) { const __attribute__((address_space(4))) char* p = F.kargs; asm volatile("" : "+s"(p)); return *(const float* const __attribute__((address_space(4)))*)(p + 8 * i); }
__device__ __forceinline__ float* outp(const Frame& F) { const __attribute__((address_space(4))) char* p = F.kargs; asm volatile("" : "+s"(p)); return *(float* const __attribute__((address_space(4)))*)(p + 8 * 21); }
enum { IN_X = 0, IN_AB_W_IN, IN_A_NORM_G, IN_A_W_S, IN_A_B_S, IN_B_CONV_W, IN_AB_W_OUT, IN_C_W_IN, IN_C_W_GRP, IN_C_SCALE, IN_C_W_OUT, IN_LN_MIX_G, IN_LN_MIX_B,
       IN_ROUTER_W, IN_ROUTER_B, IN_MOE_W_UP, IN_MOE_B_UP, IN_MOE_W_DOWN, IN_MOE_B_DOWN, IN_LN_FFN_G, IN_LN_FFN_B };

__device__ __forceinline__ void frame_refresh(Frame& F) { int t = threadIdx.x; asm volatile("" : "+v"(t)); F.tid = t; F.lane = t & 63; F.wave = __builtin_amdgcn_readfirstlane(t >> 6); }
__device__ __forceinline__ float wave_sum(float v) {
#pragma unroll
    for (int o = 1; o < 64; o <<= 1) v += __shfl_xor(v, o);
    return v;
}

__host__ __device__ __forceinline__ int conv_row(int kind, int s) {
    if (kind == 0) return s;
    const int n = s >> 10, rem = s & 1023, j = rem >> 7, a = rem & 127;
    return 256 * j + 128 * (a >> 6) + 32 * ((a >> 4) & 3) + 16 * n + (a & 15);
}
__device__ __forceinline__ void conv_item(const float* W, int K, int N, bf16* WT, int kind, LAS float* scr, int item, int lane) {
    const int nblk = N / 64, kb = item / nblk, nb = item - kb * nblk, k0 = 64 * kb, n0 = 64 * nb;
    f32x4 v[16];
    const float* src = W + (size_t)(k0 + (lane >> 4)) * N + n0 + 4 * (lane & 15);
#pragma unroll
    for (int i = 0; i < 16; ++i) v[i] = *(const f32x4*)(src + (size_t)(4 * i) * N);
#pragma unroll
    for (int i = 0; i < 16; ++i) { LAS float* d = scr + (4 * i + (lane >> 4)) * 65 + 4 * (lane & 15); d[0] = v[i][0]; d[1] = v[i][1]; d[2] = v[i][2]; d[3] = v[i][3]; }
    LDS_WAIT(); asm volatile("" ::: "memory");
    const int c = lane & 7;
#pragma unroll
    for (int j = 0; j < 8; ++j) { const int n = (lane >> 3) + 8 * j; const LAS float* s = scr + (8 * c) * 65 + n;
        v4u o; o.x = pk2(s[0 * 65], s[1 * 65]); o.y = pk2(s[2 * 65], s[3 * 65]); o.z = pk2(s[4 * 65], s[5 * 65]); o.w = pk2(s[6 * 65], s[7 * 65]);
        *(v4u*)(WT + (size_t)conv_row(kind, n0 + n) * K + k0 + 8 * c) = o; }
    LDS_WAIT(); asm volatile("" ::: "memory");
}
__device__ __forceinline__ void phase_conv(Frame& F) {
    frame_refresh(F);
    LAS float* scr = (LAS float*)(F.lds + F.wave * 16640);
    const int gw = F.vcu * NWAVES + F.wave, NGW = F.G * NWAVES;
    constexpr int I0 = 2 * 16 * 40, I1 = 2 * 256, I4 = 8 * 16, I5 = 128 * 512, I6 = 128 * 256;
    constexpr int NITEMS = I0 + 3 * I1 + I4 + I5 + I6;
    for (int it = gw; it < NITEMS; it += NGW) {
        int r = it; const float* src; bf16* dst; int K, N, kind = 0, per;
        if (r < I0) { src = inp(F, IN_AB_W_IN); dst = (bf16*)(F.ws + WS_WIN); K = 1024; N = 2560; per = 640; }
        else if ((r -= I0) < I1) { src = inp(F, IN_AB_W_OUT); dst = (bf16*)(F.ws + WS_WOUT); K = 1024; N = 1024; per = 256; }
        else if ((r -= I1) < I1) { src = inp(F, IN_C_W_IN); dst = (bf16*)(F.ws + WS_CIN); K = 1024; N = 1024; per = 256; }
        else if ((r -= I1) < I1) { src = inp(F, IN_C_W_OUT); dst = (bf16*)(F.ws + WS_COUT); K = 1024; N = 1024; per = 256; }
        else if ((r -= I1) < I4) { src = inp(F, IN_C_W_GRP); dst = (bf16*)(F.ws + WS_CGRP); K = 256; N = 256; per = 16; }
        else if ((r -= I4) < I5) { src = inp(F, IN_MOE_W_UP); dst = (bf16*)(F.ws + WS_WUP); K = 1024; N = 2048; per = 512; kind = 1; }
        else { r -= I5; src = inp(F, IN_MOE_W_DOWN); dst = (bf16*)(F.ws + WS_WDN); K = 1024; N = 1024; per = 256; }
        const int mat = r / per, item = r - mat * per;
        conv_item(src + (size_t)mat * K * N, K, N, dst + (size_t)mat * K * N, kind, scr, item, F.lane);
    }
    const int gt = F.vcu * (NWAVES * 64) + F.tid, NGT = F.G * NWAVES * 64;
    {
        const f32x4* xs = (const f32x4*)inp(F, IN_X); f32x4* X = (f32x4*)(F.ws + WS_X); v2u* XB = (v2u*)(F.ws + WS_XB);
        for (int i = gt; i < M * D / 4; i += NGT) { const f32x4 v = xs[i]; X[i] = v; v2u w; w.x = pk2(v[0], v[1]); w.y = pk2(v[2], v[3]); XB[i] = w; }
    }
    {
        const f32x4* ws4 = (const f32x4*)inp(F, IN_A_W_S); v2u* o = (v2u*)(F.ws + WS_WSB);
        for (int i = gt; i < 2 * 8 * 128 * 128 / 4; i += NGT) { const f32x4 v = ws4[i]; const int s = (i & 31) * 4, t = (i >> 5) & 127;
            v2u w; w.x = pk2(s <= t ? v[0] : 0.f, s + 1 <= t ? v[1] : 0.f); w.y = pk2(s + 2 <= t ? v[2] : 0.f, s + 3 <= t ? v[3] : 0.f); o[i] = w; }
    }
}

__device__ __forceinline__ void phase_mixer(Frame& F, int il) {
    frame_refresh(F);
    constexpr int ZLD = PROJ, PS = 136;
    const bf16* Z = (const bf16*)(F.ws + WS_Z); bf16* Y = (bf16*)(F.ws + WS_Y);
    const bf16* Wsb = (const bf16*)(F.ws + WS_WSB) + (size_t)il * 8 * 128 * 128;
    const float* ng = inp(F, IN_A_NORM_G) + il * 512; const float* bs = inp(F, IN_A_B_S) + il * 8 * 128; const float* cw = inp(F, IN_B_CONV_W) + il * 3 * 512;
    LAS bf16* vnT = (LAS bf16*)F.lds;
    const int tid = F.tid, lane = F.lane, w = F.wave, fr = lane & 15, fq = lane >> 4;
    for (int unit = F.vcu; unit < 256; unit += F.G) {
        const int c = unit >> 1, hh = unit & 1, t0 = c * 128;
        const int s = tid >> 2, q = tid & 3;
        const bf16* zr = Z + (size_t)(t0 + s) * ZLD;
        float sum = 0.f, sq = 0.f;
#pragma unroll
        for (int i = 0; i < 16; ++i) { const v4u u4 = *(const v4u*)(zr + 512 + 128 * q + 8 * i);
#pragma unroll
            for (int e = 0; e < 4; ++e) { const float a = bflo(u4[e]), b = bfhi(u4[e]); sum += a + b; sq += a * a + b * b; } }
        sum += __shfl_xor(sum, 1); sq += __shfl_xor(sq, 1); sum += __shfl_xor(sum, 2); sq += __shfl_xor(sq, 2);
        const float mean = sum * (1.f / 512.f); const float var = fmaxf(sq * (1.f / 512.f) - mean * mean, 0.f); const float rstd = 1.0f / sqrtf(var + LN_EPS);
#pragma unroll
        for (int i = 0; i < 8; ++i) { const int dl = 64 * q + 8 * i; const v4u u4 = *(const v4u*)(zr + 512 + 256 * hh + dl);
            const f32x4 g0 = *(const f32x4*)(ng + 256 * hh + dl), g1 = *(const f32x4*)(ng + 256 * hh + dl + 4);
            float vv[8]; vv[0] = bflo(u4[0]); vv[1] = bfhi(u4[0]); vv[2] = bflo(u4[1]); vv[3] = bfhi(u4[1]); vv[4] = bflo(u4[2]); vv[5] = bfhi(u4[2]); vv[6] = bflo(u4[3]); vv[7] = bfhi(u4[3]);
#pragma unroll
            for (int e = 0; e < 8; ++e) { const float gg = e < 4 ? g0[e & 3] : g1[e & 3]; const float y = (vv[e] - mean) * rstd * gg;
                vnT[(dl + e) * PS + s] = (bf16)(pk2(y, 0.f) & 0xffffu); } }
        __syncthreads();
        const int hq = w >> 1, h = 4 * hh + hq, dbase = 64 * hq + 32 * (w & 1);
        bf16x8 afr[2][4];
#pragma unroll
        for (int dt = 0; dt < 2; ++dt)
#pragma unroll
            for (int kk = 0; kk < 4; ++kk) afr[dt][kk] = *(const LAS bf16x8*)(vnT + (dbase + 16 * dt + fr) * PS + 32 * kk + 8 * fq);
        const bf16* Wh = Wsb + (size_t)h * 128 * 128;
#pragma unroll
        for (int ti = 0; ti < 8; ++ti) {
            f32x4 acc[2] = {(f32x4){0.f, 0.f, 0.f, 0.f}, (f32x4){0.f, 0.f, 0.f, 0.f}};
#pragma unroll
            for (int kk = 0; kk < 4; ++kk) if (kk <= (ti >> 1)) {
                const bf16x8 wf = *(const bf16x8*)(Wh + (size_t)(16 * ti + fr) * 128 + 32 * kk + 8 * fq);
                acc[0] = __builtin_amdgcn_mfma_f32_16x16x32_bf16(afr[0][kk], wf, acc[0], 0, 0, 0);
                acc[1] = __builtin_amdgcn_mfma_f32_16x16x32_bf16(afr[1][kk], wf, acc[1], 0, 0, 0);
            }
            const int t = 16 * ti + fr; const float bsv = bs[h * 128 + t];
#pragma unroll
            for (int dt = 0; dt < 2; ++dt) { const int col = 64 * h + 32 * (w & 1) + 16 * dt + 4 * fq;
                const v2u u2 = *(const v2u*)(Z + (size_t)(t0 + t) * ZLD + col);
                v2u o; o.x = pk2(bflo(u2.x) * (acc[dt][0] + bsv), bfhi(u2.x) * (acc[dt][1] + bsv)); o.y = pk2(bflo(u2.y) * (acc[dt][2] + bsv), bfhi(u2.y) * (acc[dt][3] + bsv));
                *(v2u*)(Y + (size_t)(t0 + t) * D + col) = o; }
        }
#pragma unroll 1
        for (int i = 0; i < 8; ++i) { const int id = tid + 512 * i, r = id >> 5, col = 256 * hh + 8 * (id & 31), t = t0 + r;
            float a[8];
#pragma unroll
            for (int e = 0; e < 8; ++e) a[e] = 0.f;
#pragma unroll
            for (int k = 0; k < 3; ++k) { const int tt = t - 2 + k; if (tt >= 0) {
                const v4u gc = *(const v4u*)(Z + (size_t)tt * ZLD + 1536 + col), xi = *(const v4u*)(Z + (size_t)tt * ZLD + 2048 + col);
                const f32x4 w0 = *(const f32x4*)(cw + k * 512 + col), w1 = *(const f32x4*)(cw + k * 512 + col + 4);
#pragma unroll
                for (int e = 0; e < 4; ++e) { const float wl = e < 2 ? w0[2 * e] : w1[2 * e - 4], wh = e < 2 ? w0[2 * e + 1] : w1[2 * e - 3];
                    a[2 * e] += wl * bflo(gc[e]) * bflo(xi[e]); a[2 * e + 1] += wh * bfhi(gc[e]) * bfhi(xi[e]); } } }
            const v4u gb = *(const v4u*)(Z + (size_t)t * ZLD + 1024 + col);
            v4u o;
#pragma unroll
            for (int e = 0; e < 4; ++e) o[e] = pk2(bflo(gb[e]) * a[2 * e], bfhi(gb[e]) * a[2 * e + 1]);
            *(v4u*)(Y + (size_t)t * D + 512 + col) = o; }
        __syncthreads();
    }
}

__device__ __forceinline__ void phase_pool(Frame& F) {
    frame_refresh(F);
    const bf16* Zc = (const bf16*)(F.ws + WS_Z); bf16* P = (bf16*)(F.ws + WS_Z + 32 * MiB);
    const int gt = F.vcu * (NWAVES * 64) + F.tid, NGT = F.G * NWAVES * 64;
    for (int id = gt; id < (M / 16) * 128; id += NGT) {
        const int vec = id & 127, run = id >> 7, col = 8 * vec, win = 2 << (col >> 8), t0 = run * 16;
        float S[8];
#pragma unroll
        for (int e = 0; e < 8; ++e) S[e] = 0.f;
        for (int tt = (t0 - win + 1 > 0 ? t0 - win + 1 : 0); tt < t0; ++tt) { const v4u z = *(const v4u*)(Zc + (size_t)tt * D + col);
#pragma unroll
            for (int e = 0; e < 4; ++e) { S[2 * e] += bflo(z[e]); S[2 * e + 1] += bfhi(z[e]); } }
#pragma unroll 4
        for (int r = 0; r < 16; ++r) { const int t = t0 + r; const v4u z = *(const v4u*)(Zc + (size_t)t * D + col);
            float zf[8];
#pragma unroll
            for (int e = 0; e < 4; ++e) { zf[2 * e] = bflo(z[e]); zf[2 * e + 1] = bfhi(z[e]); }
#pragma unroll
            for (int e = 0; e < 8; ++e) S[e] += zf[e];
            const int cnt = (t + 1 < win) ? t + 1 : win; const float inv = 1.0f / (float)cnt;
            v4u o;
#pragma unroll
            for (int e = 0; e < 4; ++e) o[e] = pk2(S[2 * e] * inv - zf[2 * e], S[2 * e + 1] * inv - zf[2 * e + 1]);
            *(v4u*)(P + (size_t)t * D + col) = o;
            if (t - win + 1 >= 0) { const v4u zo = *(const v4u*)(Zc + (size_t)(t - win + 1) * D + col);
#pragma unroll
                for (int e = 0; e < 4; ++e) { S[2 * e] -= bflo(zo[e]); S[2 * e + 1] -= bfhi(zo[e]); } } }
    }
}

__device__ __forceinline__ void phase_lnr(Frame& F, int layer) {
    frame_refresh(F);
    constexpr int XP = 1028, PP = 33;
    LAS float* xs = (LAS float*)F.lds;
    LAS float* part = (LAS float*)(F.lds + 32 * XP * 4);
    LAS int* lcnt = (LAS int*)(F.lds + 32 * XP * 4 + 2 * 32 * PP * 4);
    LAS int* lbase = lcnt + 32;
    LAS int* lrow = lbase + 32;
    static_assert(32 * XP * 4 + 2 * 32 * PP * 4 + (32 + 32 + 128) * 4 <= SCR_BYTES, "lnr LDS");
    float* X = (float*)(F.ws + WS_X); bf16* XB = (bf16*)(F.ws + WS_XB); bf16* XPAD = (bf16*)(F.ws + WS_XPAD);
    int* rowmap = (int*)(F.ws + WS_ROWMAP); float* gates = (float*)(F.ws + WS_GATES);
    const float* rw = inp(F, IN_ROUTER_W) + (size_t)layer * D * NE; const float* rb = inp(F, IN_ROUTER_B) + layer * NE;
    unsigned* gcnt = F.ctl + CW_CNT + layer * 32 * 64;
    const int tid = F.tid, lane = F.lane, w = F.wave;
    f32x4 g4[4], b4[4];
#pragma unroll
    for (int j = 0; j < 4; ++j) { g4[j] = *(const f32x4*)(inp(F, IN_LN_MIX_G) + layer * D + 4 * lane + 256 * j); b4[j] = *(const f32x4*)(inp(F, IN_LN_MIX_B) + layer * D + 4 * lane + 256 * j); }
    for (int blk = F.vcu; blk < M / 32; blk += F.G) {
        const int t0 = blk * 32;
        if (tid < 32) lcnt[tid] = 0;
#pragma unroll 1
        for (int rr = 0; rr < 4; ++rr) { const int tl = 4 * w + rr; const size_t row = (size_t)(t0 + tl);
            f32x4* xr = (f32x4*)(X + row * D) + lane; f32x4 v[4]; float s = 0.f;
#pragma unroll
            for (int j = 0; j < 4; ++j) { v[j] = xr[64 * j]; s += (v[j][0] + v[j][1]) + (v[j][2] + v[j][3]); }
            const float mean = wave_sum(s) * (1.f / D); float s2 = 0.f;
#pragma unroll
            for (int j = 0; j < 4; ++j) { v[j] = v[j] - mean; s2 += (v[j][0] * v[j][0] + v[j][1] * v[j][1]) + (v[j][2] * v[j][2] + v[j][3] * v[j][3]); }
            const float rstd = 1.0f / sqrtf(wave_sum(s2) * (1.f / D) + LN_EPS);
            v2u* xb = (v2u*)(XB + row * D) + lane;
#pragma unroll
            for (int j = 0; j < 4; ++j) { const f32x4 y = v[j] * rstd * g4[j] + b4[j]; xr[64 * j] = y; v2u p; p.x = pk2(y[0], y[1]); p.y = pk2(y[2], y[3]); xb[64 * j] = p;
                *(LAS f32x4*)(xs + tl * XP + 4 * lane + 256 * j) = y; } }
        __syncthreads();
        { const int tt = w & 1, eh = (w >> 1) & 1, kh = w >> 2, i = lane & 15, h = lane >> 4;
            const LAS float* xa = xs + (16 * tt + i) * XP + 512 * kh + 4 * h;
            const float* rwp = rw + (size_t)(512 * kh + 4 * h) * NE + 16 * eh + i;
            f32x4 acc = (f32x4){0.f, 0.f, 0.f, 0.f};
#pragma unroll 4
            for (int s = 0; s < 32; ++s) { const f32x4 a4 = *(const LAS f32x4*)(xa + 16 * s);
#pragma unroll
                for (int j = 0; j < 4; ++j) acc = __builtin_amdgcn_mfma_f32_16x16x4f32(a4[j], rwp[(16 * s + j) * NE], acc, 0, 0, 0); }
#pragma unroll
            for (int r = 0; r < 4; ++r) part[(kh * 32 + 16 * tt + 4 * h + r) * PP + 16 * eh + i] = acc[r]; }
        __syncthreads();
        int te[4] = {0, 0, 0, 0}, rk[4] = {0, 0, 0, 0}; float gk[4] = {0.f, 0.f, 0.f, 0.f};
        if (tid < 32) { LAS float* p0 = part + tid * PP; const LAS float* p1 = part + (32 + tid) * PP;
            for (int e = 0; e < 32; ++e) p0[e] = p0[e] + p1[e] + rb[e];
            unsigned mask = 0u; float tv[4];
#pragma unroll
            for (int k = 0; k < 4; ++k) { float best = -3.0e38f; int bi = 0;
                for (int e = 0; e < 32; ++e) { const float v = p0[e]; const bool take = (((mask >> e) & 1u) == 0u) && (v > best); best = take ? v : best; bi = take ? e : bi; }
                mask |= 1u << bi; tv[k] = best; te[k] = bi; }
            float ssum = 0.f;
#pragma unroll
            for (int k = 0; k < 4; ++k) { gk[k] = __expf(tv[k] - tv[0]); ssum += gk[k]; }
            const float inv = 1.0f / ssum;
#pragma unroll
            for (int k = 0; k < 4; ++k) { gk[k] *= inv; rk[k] = __hip_atomic_fetch_add(lcnt + te[k], 1, __ATOMIC_RELAXED, __HIP_MEMORY_SCOPE_WORKGROUP); } }
        __syncthreads();
        if (tid < 32) { const int c = lcnt[tid]; lbase[tid] = c ? (int)__hip_atomic_fetch_add(gcnt + tid * 64, (unsigned)c, RLX_AGENT) : 0; }
        __syncthreads();
        if (tid < 32) {
#pragma unroll
            for (int k = 0; k < 4; ++k) { const int row = te[k] * CAP + lbase[te[k]] + rk[k]; rowmap[(t0 + tid) * 4 + k] = row; gates[(t0 + tid) * 4 + k] = gk[k]; lrow[tid * 4 + k] = row; } }
        __syncthreads();
#pragma unroll 1
        for (int rr = 0; rr < 4; ++rr) { const int tl = 4 * w + rr; v2u p[4];
#pragma unroll
            for (int j = 0; j < 4; ++j) { const f32x4 y = *(const LAS f32x4*)(xs + tl * XP + 4 * lane + 256 * j); p[j].x = pk2(y[0], y[1]); p[j].y = pk2(y[2], y[3]); }
#pragma unroll
            for (int k = 0; k < 4; ++k) { v2u* dst = (v2u*)(XPAD + (size_t)lrow[tl * 4 + k] * D) + lane;
#pragma unroll
                for (int j = 0; j < 4; ++j) dst[64 * j] = p[j]; } }
        __syncthreads();
    }
}

__device__ __forceinline__ void build_units(Frame& F, int layer, int NT) {
    frame_refresh(F);
    LAS int* list = (LAS int*)(F.lds + LIST_OFF);
    if (F.tid < 64) { unsigned* gcnt = F.ctl + CW_CNT + layer * 32 * 64; const int L = F.tid * F.G + F.vcu; int pref = 0, found = -1;
        for (int e = 0; e < NE; ++e) { const int c = (int)__hip_atomic_load(gcnt + e * 64, RLX_AGENT), tiles = (c + 255) >> 8, ue = tiles * NT;
            if (found < 0 && L < pref + ue) { const int idx = L - pref, j = idx / tiles, mi = idx - j * tiles; found = e | (mi << 8) | (j << 20); }
            pref += ue; }
        list[F.tid] = found; }
    __syncthreads();
}

__device__ __forceinline__ void phase_combine(Frame& F, int layer) {
    frame_refresh(F);
    float* X = (float*)(F.ws + WS_X); bf16* XB = (bf16*)(F.ws + WS_XB); const bf16* YPAD = (const bf16*)(F.ws + WS_XPAD);
    const int* rowmap = (const int*)(F.ws + WS_ROWMAP); const float* gates = (const float*)(F.ws + WS_GATES);
    const int lane = F.lane, gw = F.vcu * NWAVES + F.wave, NGW = F.G * NWAVES;
    f32x4 g4[4], b4[4];
#pragma unroll
    for (int j = 0; j < 4; ++j) { g4[j] = *(const f32x4*)(inp(F, IN_LN_FFN_G) + layer * D + 4 * lane + 256 * j); b4[j] = *(const f32x4*)(inp(F, IN_LN_FFN_B) + layer * D + 4 * lane + 256 * j); }
    float* dstbase = (layer == DEPTH - 1) ? outp(F) : X;
    for (int t = gw; t < M; t += NGW) {
        const f32x4* xr = (const f32x4*)(X + (size_t)t * D) + lane; f32x4 v[4];
#pragma unroll
        for (int j = 0; j < 4; ++j) v[j] = xr[64 * j] * ALPHA;
#pragma unroll
        for (int k = 0; k < 4; ++k) { const int row = rowmap[t * 4 + k]; const float g = gates[t * 4 + k]; const v2u* yr = (const v2u*)(YPAD + (size_t)row * D) + lane;
#pragma unroll
            for (int j = 0; j < 4; ++j) { const v2u y = yr[64 * j]; v[j][0] += g * bflo(y.x); v[j][1] += g * bfhi(y.x); v[j][2] += g * bflo(y.y); v[j][3] += g * bfhi(y.y); } }
        float s = 0.f;
#pragma unroll
        for (int j = 0; j < 4; ++j) s += (v[j][0] + v[j][1]) + (v[j][2] + v[j][3]);
        const float mean = wave_sum(s) * (1.f / D); float s2 = 0.f;
#pragma unroll
        for (int j = 0; j < 4; ++j) { v[j] = v[j] - mean; s2 += (v[j][0] * v[j][0] + v[j][1] * v[j][1]) + (v[j][2] * v[j][2] + v[j][3] * v[j][3]); }
        const float rstd = 1.0f / sqrtf(wave_sum(s2) * (1.f / D) + LN_EPS);
        f32x4* xo = (f32x4*)(dstbase + (size_t)t * D) + lane; v2u* xb = (v2u*)(XB + (size_t)t * D) + lane;
#pragma unroll
        for (int j = 0; j < 4; ++j) { const f32x4 y = v[j] * rstd * g4[j] + b4[j]; xo[64 * j] = y; v2u p; p.x = pk2(y[0], y[1]); p.y = pk2(y[2], y[3]); xb[64 * j] = p; }
    }
}

constexpr int N_PHASES = 31;
struct Args { const float* in[21]; float* out; unsigned char* ws; int ph_lo, ph_hi; };
static_assert(sizeof(Args) == 21 * 8 + 8 + 8 + 8, "Args has no padding");

__global__ void __launch_bounds__(NWAVES * 64, 2) fwd(Args args) {
    extern __shared__ __attribute__((aligned(16))) unsigned char lds_raw[];
    Frame F;
    F.lds = (LAS unsigned char*)lds_raw;
    F.MISC = (volatile LAS unsigned*)(F.lds + MISC_OFF);
    F.tid = threadIdx.x; F.lane = F.tid & 63; F.wave = __builtin_amdgcn_readfirstlane(F.tid >> 6);
    F.G = gridDim.x; { const int bx = blockIdx.x; F.vcu = (F.G % 8 == 0) ? (bx % 8) * (F.G / 8) + bx / 8 : bx; }
    F.ws = args.ws; F.ctl = (unsigned*)(args.ws + WS_CTL); F.kargs = (const __attribute__((address_space(4))) char*)__builtin_amdgcn_kernarg_segment_ptr();
    for (int u = F.tid; u < (LDS_BYTES - LDSCTL_OFF) / 4; u += NWAVES * 64) ((LAS unsigned*)(F.lds + LDSCTL_OFF))[u] = 0u;
    __syncthreads();
    const int lo = args.ph_lo, hi = args.ph_hi;
    XcdBarrier bar; bar.bar = F.ctl + CW_BAR; bar.x = 0; bar.st = nullptr;
    if (hi - lo > 1) bar = xcd_barrier_post(F.ctl + CW_BAR, F.MISC + 8);
#define IN(k) (lo <= (k) && (k) < hi)
#define SEAM(k) do { if (IN(k) && IN((k) + 1)) xcd_barrier(bar); } while (0)
    LAS unsigned char* const lds = F.lds;

    if (IN(0)) { phase_conv(F); } SEAM(0);

#pragma unroll 1
    for (int L = 0; L < DEPTH; ++L) {
        const int odd = L & 1, il = L >> 1, base = 1 + il * 15 + odd * 7;
        const int k_in = base, k_mix = base + 1, k_grp = base + 2, k_out = base + 2 + odd, k_lnr = k_out + 1, k_up = k_out + 2, k_dn = k_out + 3, k_cb = k_out + 4;
        if (IN(k_in)) {
            pg8::DenseOrder S; S.init(F.ws + WS_XB, odd ? (F.ws + WS_CIN + (size_t)il * D * D * 2) : (F.ws + WS_WIN + (size_t)il * PROJ * D * 2), D, D, 0, M, odd ? D : PROJ, F.G, (int)blockIdx.x);
            pg8::EpiB16 E{(bf16*)(F.ws + WS_Z), odd ? D : PROJ, nullptr, nullptr, odd ? 0 : 4};
            pg8::gemm_phase<pg8::EpiB16, pg8::DenseOrder>(lds, D, D, D, S, E);
        }
        SEAM(k_in);
        if (IN(k_mix)) { if (odd) phase_pool(F); else phase_mixer(F, il); }
        SEAM(k_mix);
        if (odd && IN(k_grp)) {
            pg8::DenseOrder S; S.init(F.ws + WS_Z + 32 * MiB, F.ws + WS_CGRP + (size_t)il * 4 * 256 * 256 * 2, D, 256, 512, M, D, F.G, (int)blockIdx.x);
            pg8::EpiB16 E{(bf16*)(F.ws + WS_Y), D, nullptr, inp(F, IN_C_SCALE) + il * D, 0};
            pg8::gemm_phase<pg8::EpiB16, pg8::DenseOrder>(lds, 256, D, 256, S, E);
        }
        if (odd) SEAM(k_grp);
        if (IN(k_out)) {
            pg8::DenseOrder S; S.init(F.ws + WS_Y, odd ? (F.ws + WS_COUT + (size_t)il * D * D * 2) : (F.ws + WS_WOUT + (size_t)il * D * D * 2), D, D, 0, M, D, F.G, (int)blockIdx.x);
            pg8::EpiRes E{(float*)(F.ws + WS_X), D, ALPHA};
            pg8::gemm_phase<pg8::EpiRes, pg8::DenseOrder>(lds, D, D, D, S, E);
        }
        SEAM(k_out);
        if (IN(k_lnr)) phase_lnr(F, L);
        SEAM(k_lnr);
        if (IN(k_up)) {
            build_units(F, L, 8);
            pg8::ListOrder S{(const LAS int*)(lds + LIST_OFF), (const char*)(F.ws + WS_XPAD), (const char*)(F.ws + WS_WUP + (size_t)L * 32 * 2048 * 1024 * 2), (size_t)CAP * D * 2, (size_t)2048 * 1024 * 2, D, D, CAP, 128, 2048, 128};
            pg8::EpiSwiglu E{(bf16*)(F.ws + WS_HACT), inp(F, IN_MOE_B_UP) + (size_t)L * 32 * 2048};
            pg8::gemm_phase<pg8::EpiSwiglu, pg8::ListOrder>(lds, D, D, D, S, E);
        }
        SEAM(k_up);
        if (IN(k_dn)) {
            build_units(F, L, 4);
            pg8::ListOrder S{(const LAS int*)(lds + LIST_OFF), (const char*)(F.ws + WS_HACT), (const char*)(F.ws + WS_WDN + (size_t)L * 32 * 1024 * 1024 * 2), (size_t)CAP * D * 2, (size_t)1024 * 1024 * 2, D, D, CAP, 256, 1024, 256};
            pg8::EpiB16 E{(bf16*)(F.ws + WS_XPAD), D, inp(F, IN_MOE_B_DOWN) + (size_t)L * 32 * 1024, nullptr, 0};
            pg8::gemm_phase<pg8::EpiB16, pg8::ListOrder>(lds, D, D, D, S, E);
        }
        SEAM(k_dn);
        if (IN(k_cb)) phase_combine(F, L);
        SEAM(k_cb);
    }
#undef IN
#undef SEAM
}

extern "C" void kernel_launch(void* const* d_in, const int* in_sizes, int n_in, void* d_out, int out_size, void* d_ws, size_t ws_size, hipStream_t stream) {
    static int grid = 0;
    if (grid == 0) {
        if (n_in != 21 || out_size != M * D || ws_size < WS_END) { fprintf(stderr, "kernel_launch: unexpected shapes (n_in %d, out %d, ws %zu)\n", n_in, out_size, ws_size); grid = -1; return; }
        int dev = 0, cus = 0, per_cu = 0;
        if (hipGetDevice(&dev) != hipSuccess || hipDeviceGetAttribute(&cus, hipDeviceAttributeMultiprocessorCount, dev) != hipSuccess) { grid = -1; return; }
        if (hipFuncSetAttribute((const void*)fwd, hipFuncAttributeMaxDynamicSharedMemorySize, LDS_BYTES) != hipSuccess) { fprintf(stderr, "kernel_launch: hipFuncSetAttribute failed\n"); grid = -1; return; }
        if (hipOccupancyMaxActiveBlocksPerMultiprocessor(&per_cu, (const void*)fwd, NWAVES * 64, LDS_BYTES) != hipSuccess || per_cu < 1)
            fprintf(stderr, "kernel_launch: note: occupancy query reports %d workgroups per CU\n", per_cu);
        (void)hipGetLastError();
        grid = cus;
    }
    if (grid < 0) return;
    (void)in_sizes;
    if (hipMemsetAsync((char*)d_ws + WS_CTL, 0, CTL_ZERO_BYTES, stream) != hipSuccess) return;
    Args a{};
    for (int i = 0; i < 21; ++i) a.in[i] = (const float*)d_in[i];
    a.out = (float*)d_out; a.ws = (unsigned char*)d_ws;
#if MK_PER_PHASE
    for (int p = 0; p < N_PHASES; ++p) { a.ph_lo = p; a.ph_hi = p + 1; hipLaunchKernelGGL(fwd, dim3(grid), dim3(NWAVES * 64), LDS_BYTES, stream, a); }
#else
    a.ph_lo = 0; a.ph_hi = N_PHASES; hipLaunchKernelGGL(fwd, dim3(grid), dim3(NWAVES * 64), LDS_BYTES, stream, a);
#endif
}
```
